# Optimizing an MI355X kernel written in HIP

```python
import jax, jax.numpy as jnp
from jax import lax
import numpy as np


D_MODEL = 1024
BATCH = 8
SEQ = 2048
DEPTH = 4

GM_GROUPS = 8
GM_GROUP_DIM = D_MODEL // 16
GM_WIDTH = GM_GROUPS * GM_GROUP_DIM
GM_CHUNK = 128
ATTN_HEADS = 8
HEAD_DIM = D_MODEL // 16
ATTN_WIDTH = ATTN_HEADS * HEAD_DIM
MOBA_BLOCK = 256
MOBA_TOPK = 3
MOBA_QCHUNK = 32
ROPE_THETA = 10000.0
D_FF = -(-8 * D_MODEL // (3 * 256)) * 256
IN_WIDTH = 2 * GM_WIDTH + 3 * ATTN_WIDTH + 2 * D_MODEL
NORM_EPS = 1e-6
NEG_INF = -1e30

kernel_name = 'hybrid_gmlp_moba_block'


def rms_norm(x, g):
    xf = x.astype(jnp.float32)
    y = xf * lax.rsqrt(jnp.mean(xf * xf, axis=-1, keepdims=True) + NORM_EPS)
    return (y * g.astype(jnp.float32)).astype(x.dtype)


def layer_norm(x, g, b):
    xf = x.astype(jnp.float32)
    mu = jnp.mean(xf, axis=-1, keepdims=True)
    var = jnp.mean(jnp.square(xf - mu), axis=-1, keepdims=True)
    y = (xf - mu) * lax.rsqrt(var + NORM_EPS)
    return (y * g.astype(jnp.float32) + b.astype(jnp.float32)).astype(x.dtype)


def rope_tables(positions):
    inv_freq = 1.0 / (ROPE_THETA ** (jnp.arange(0, HEAD_DIM, 2, dtype=jnp.float32) / HEAD_DIM))
    ang = positions.astype(jnp.float32)[..., None] * inv_freq
    return jnp.cos(ang)[:, :, None, :], jnp.sin(ang)[:, :, None, :]


def apply_rope(x, cos, sin):
    xf = x.astype(jnp.float32)
    x1, x2 = jnp.split(xf, 2, axis=-1)
    return jnp.concatenate([x1 * cos - x2 * sin, x2 * cos + x1 * sin], axis=-1).astype(x.dtype)


def spatial_gating_unit(u, v, w_s, b_s, ln_g, ln_b):
    B, S, _ = v.shape
    n_chunks = S // GM_CHUNK
    v = layer_norm(v, ln_g, ln_b)
    vc = v.reshape(B, n_chunks, GM_CHUNK, GM_GROUPS, GM_GROUP_DIM)
    causal = jnp.tril(jnp.ones((GM_CHUNK, GM_CHUNK), dtype=bool))
    w = jnp.where(causal, w_s, jnp.zeros((), w_s.dtype))
    mixed = jnp.einsum('gij,bcjgd->bcigd', w, vc) + b_s.T[None, None, :, :, None]
    return u * mixed.reshape(B, S, GM_WIDTH)


def moba_attention(q, k, v):
    B, H, S, hd = q.shape
    s_pad = -(-S // MOBA_BLOCK) * MOBA_BLOCK
    pad = ((0, 0), (0, 0), (0, s_pad - S), (0, 0))
    q = jnp.pad(q, pad)
    k = jnp.pad(k, pad)
    v = jnp.pad(v, pad)
    n_blocks = s_pad // MOBA_BLOCK
    topk = max(1, min(MOBA_TOPK, n_blocks - 1))
    scale = HEAD_DIM ** -0.5

    kb = k.reshape(B, H, n_blocks, MOBA_BLOCK, hd)
    vb = v.reshape(B, H, n_blocks, MOBA_BLOCK, hd)
    kbar = jnp.mean(kb.astype(jnp.float32), axis=3)
    gate = jnp.einsum('bhsd,bhnd->bhsn', q.astype(jnp.float32), kbar)
    q_block = jnp.arange(s_pad) // MOBA_BLOCK
    fully_past = jnp.arange(n_blocks)[None, :] < q_block[:, None]
    gate = jnp.where(fully_past, gate, -jnp.inf)
    _, idx = lax.top_k(gate, topk)
    valid = idx < q_block[:, None]

    n_q = s_pad // MOBA_QCHUNK
    qc = q.reshape(B, H, n_q, MOBA_QCHUNK, hd).transpose(2, 0, 1, 3, 4)
    idxc = idx.reshape(B, H, n_q, MOBA_QCHUNK, topk).transpose(2, 0, 1, 3, 4)
    validc = valid.reshape(B, H, n_q, MOBA_QCHUNK, topk).transpose(2, 0, 1, 3, 4)
    bi = jnp.arange(B)[:, None, None, None]
    hi = jnp.arange(H)[None, :, None, None]

    def step(args):
        c, qq, ii, vv = args
        kg = kb[bi, hi, ii]
        vg = vb[bi, hi, ii]
        s_sel = jnp.einsum('bhqd,bhqnkd->bhqnk', qq, kg, preferred_element_type=jnp.float32) * scale
        s_sel = jnp.where(vv[..., None], s_sel, NEG_INF).reshape(B, H, MOBA_QCHUNK, topk * MOBA_BLOCK)
        blk = (c * MOBA_QCHUNK) // MOBA_BLOCK
        k_own = lax.dynamic_index_in_dim(kb, blk, axis=2, keepdims=False)
        v_own = lax.dynamic_index_in_dim(vb, blk, axis=2, keepdims=False)
        s_own = jnp.einsum('bhqd,bhkd->bhqk', qq, k_own, preferred_element_type=jnp.float32) * scale
        q_pos = c * MOBA_QCHUNK + jnp.arange(MOBA_QCHUNK)
        k_pos = blk * MOBA_BLOCK + jnp.arange(MOBA_BLOCK)
        s_own = jnp.where(k_pos[None, :] <= q_pos[:, None], s_own, NEG_INF)
        p = jax.nn.softmax(jnp.concatenate([s_sel, s_own], axis=-1), axis=-1).astype(v.dtype)
        p_sel = p[..., :topk * MOBA_BLOCK].reshape(B, H, MOBA_QCHUNK, topk, MOBA_BLOCK)
        p_own = p[..., topk * MOBA_BLOCK:]
        return (jnp.einsum('bhqnk,bhqnkd->bhqd', p_sel, vg)
                + jnp.einsum('bhqk,bhkd->bhqd', p_own, v_own))

    out = lax.map(step, (jnp.arange(n_q), qc, idxc, validc))
    out = out.transpose(1, 2, 0, 3, 4).reshape(B, H, s_pad, hd)
    return out[:, :, :S]


def hybrid_layer(x, cos, sin, w_in, w_s, b_s, ln_v_g, ln_v_b, w_proj_a, w_proj_b, w_out,
                 g_mix_pre, g_mix_post, g_ffn_pre, g_ffn_post, w_gate_up, w_down):
    B, S, _ = x.shape
    h = rms_norm(x, g_mix_pre)
    z = h @ w_in
    o1 = GM_WIDTH
    o2 = 2 * GM_WIDTH
    o3 = o2 + ATTN_WIDTH
    o4 = o3 + ATTN_WIDTH
    o5 = o4 + ATTN_WIDTH
    o6 = o5 + D_MODEL
    u, vg, q, k, va, gate_a, gate_b = jnp.split(z, [o1, o2, o3, o4, o5, o6], axis=-1)
    y_a = spatial_gating_unit(jax.nn.gelu(u), jax.nn.gelu(vg), w_s, b_s, ln_v_g, ln_v_b)
    q = apply_rope(q.reshape(B, S, ATTN_HEADS, HEAD_DIM), cos, sin).transpose(0, 2, 1, 3)
    k = apply_rope(k.reshape(B, S, ATTN_HEADS, HEAD_DIM), cos, sin).transpose(0, 2, 1, 3)
    va = va.reshape(B, S, ATTN_HEADS, HEAD_DIM).transpose(0, 2, 1, 3)
    y_b = moba_attention(q, k, va).transpose(0, 2, 1, 3).reshape(B, S, ATTN_WIDTH)
    merged = jax.nn.sigmoid(gate_a) * (y_a @ w_proj_a) + jax.nn.sigmoid(gate_b) * (y_b @ w_proj_b)
    x = x + rms_norm(merged @ w_out, g_mix_post)
    h = rms_norm(x, g_ffn_pre)
    gate, up = jnp.split(h @ w_gate_up, 2, axis=-1)
    f = (jax.nn.silu(gate) * up) @ w_down
    return x + rms_norm(f, g_ffn_post)


def setup_inputs(seed: int = 0) -> dict:
    key = jax.random.key(seed)
    ks = jax.random.split(key, 16)
    f32 = jnp.float32

    def nrm(k_, shape, fan_in):
        return jax.random.normal(k_, shape, f32) * (fan_in ** -0.5)

    def gain(k_, shape):
        return 1.0 + 0.02 * jax.random.normal(k_, shape, f32)

    x = jax.random.normal(ks[0], (BATCH, SEQ, D_MODEL), f32)
    positions = jnp.broadcast_to(jnp.arange(SEQ, dtype=jnp.int32), (BATCH, SEQ))
    return {
        'x': x,
        'positions': positions,
        'w_in': nrm(ks[1], (DEPTH, D_MODEL, IN_WIDTH), D_MODEL),
        'w_s': nrm(ks[2], (DEPTH, GM_GROUPS, GM_CHUNK, GM_CHUNK), GM_CHUNK),
        'b_s': gain(ks[3], (DEPTH, GM_GROUPS, GM_CHUNK)),
        'ln_v_g': gain(ks[4], (DEPTH, GM_WIDTH)),
        'ln_v_b': 0.02 * jax.random.normal(ks[5], (DEPTH, GM_WIDTH), f32),
        'w_proj_a': nrm(ks[6], (DEPTH, GM_WIDTH, D_MODEL), GM_WIDTH),
        'w_proj_b': nrm(ks[7], (DEPTH, ATTN_WIDTH, D_MODEL), ATTN_WIDTH),
        'w_out': nrm(ks[8], (DEPTH, D_MODEL, D_MODEL), D_MODEL),
        'g_mix_pre': gain(ks[9], (DEPTH, D_MODEL)),
        'g_mix_post': gain(ks[10], (DEPTH, D_MODEL)),
        'g_ffn_pre': gain(ks[11], (DEPTH, D_MODEL)),
        'g_ffn_post': gain(ks[12], (DEPTH, D_MODEL)),
        'w_gate_up': nrm(ks[13], (DEPTH, D_MODEL, 2 * D_FF), D_MODEL),
        'w_down': nrm(ks[14], (DEPTH, D_FF, D_MODEL), D_FF),
    }


def reference(x, positions, w_in, w_s, b_s, ln_v_g, ln_v_b, w_proj_a, w_proj_b, w_out,
              g_mix_pre, g_mix_post, g_ffn_pre, g_ffn_post, w_gate_up, w_down):
    cos, sin = rope_tables(positions)
    for l in range(DEPTH):
        x = hybrid_layer(x, cos, sin, w_in[l], w_s[l], b_s[l], ln_v_g[l], ln_v_b[l],
                         w_proj_a[l], w_proj_b[l], w_out[l], g_mix_pre[l], g_mix_post[l],
                         g_ffn_pre[l], g_ffn_post[l], w_gate_up[l], w_down[l])
    return x
```

```cpp
#include <hip/hip_runtime.h>
#include <cstdint>
#include <cstdio>

typedef unsigned short bf16;
constexpr int NBATCH = 8, SEQ = 2048, DM = 1024, MTOK = NBATCH * SEQ, DEPTH = 4;
constexpr int GW = 512, AW = 512, NH = 8, HD = 64, INW = 4608, DFF = 2816;
constexpr int NBLK = 8, MBLK = 256, GMC = 128, GMG = 8, GMD = 64;
constexpr float NORM_EPS = 1e-6f;
constexpr float QSCALE = 0.125f * 1.4426950408889634f;

__device__ __forceinline__ float bf2f(bf16 v) { return __uint_as_float((unsigned)v << 16); }
__device__ __forceinline__ bf16 f2bf(float f) { unsigned u = __float_as_uint(f); return (bf16)((u + 0x7fffu + ((u >> 16) & 1u)) >> 16); }
__device__ __forceinline__ float gelu_tanh(float x) { return 0.5f * x * (1.f + tanhf(0.7978845608028654f * (x + 0.044715f * x * x * x))); }
__device__ __forceinline__ float sigmoidf_(float x) { return 1.f / (1.f + __expf(-x)); }
__device__ __forceinline__ float wave_sum(float v) {
#pragma unroll
    for (int o = 1; o < 64; o <<= 1) v += __shfl_xor(v, o);
    return v;
}
__device__ __forceinline__ float wave_max(float v) {
#pragma unroll
    for (int o = 1; o < 64; o <<= 1) v = fmaxf(v, __shfl_xor(v, o));
    return v;
}

constexpr size_t MiB = 1u << 20;
constexpr size_t WS_COS = 1 * MiB, WS_SIN = 3 * MiB, WS_KBAR = 5 * MiB, WS_XN = 6 * MiB;
constexpr size_t WS_U = 38 * MiB, WS_VG = 54 * MiB, WS_Q = 70 * MiB, WS_K = 86 * MiB, WS_VA = 102 * MiB, WS_GA = 118 * MiB, WS_GB = 150 * MiB;
constexpr size_t WS_YA = 182 * MiB, WS_YB = 198 * MiB, WS_MERGED = 214 * MiB;
constexpr size_t WS_T1 = 182 * MiB;
constexpr size_t WS_T3 = 38 * MiB;
constexpr size_t WS_H = 38 * MiB;
constexpr size_t WS_T6 = 182 * MiB;
constexpr size_t WS_END = 246 * MiB;

__global__ void rope_table_kernel(const int* __restrict__ pos, float* __restrict__ cosT, float* __restrict__ sinT) {
    const int i = blockIdx.x * blockDim.x + threadIdx.x; if (i >= MTOK * 32) return;
    const float invf = 1.0f / powf(10000.0f, (float)(2 * (i & 31)) / 64.0f);
    const float a = (float)pos[i >> 5] * invf;
    float sv, cv; sincosf(a, &sv, &cv); cosT[i] = cv; sinT[i] = sv;
}

__global__ __launch_bounds__(256) void rms_to_bf16_kernel(const float* __restrict__ x, const float* __restrict__ g, bf16* __restrict__ xn) {
    const int row = blockIdx.x * 4 + (threadIdx.x >> 6), lane = threadIdx.x & 63;
    const float4* xr = (const float4*)(x + (size_t)row * DM) + lane;
    float4 v[4]; float ss = 0.f;
#pragma unroll
    for (int j = 0; j < 4; ++j) { v[j] = xr[64 * j]; ss += v[j].x * v[j].x + v[j].y * v[j].y + v[j].z * v[j].z + v[j].w * v[j].w; }
    const float r = rsqrtf(wave_sum(ss) * (1.f / DM) + NORM_EPS);
#pragma unroll
    for (int j = 0; j < 4; ++j) {
        const int c = lane * 4 + 256 * j; const float4 gg = *(const float4*)(g + c);
        ushort4 o; o.x = f2bf(v[j].x * r * gg.x); o.y = f2bf(v[j].y * r * gg.y); o.z = f2bf(v[j].z * r * gg.z); o.w = f2bf(v[j].w * r * gg.w);
        *(ushort4*)(xn + (size_t)row * DM + c) = o;
    }
}

__global__ __launch_bounds__(256) void rownorm_kernel(const float* __restrict__ t, const float* xin, const float* __restrict__ gpost, float* xout, const float* __restrict__ gnext, bf16* __restrict__ xn) {
    const int row = blockIdx.x * 4 + (threadIdx.x >> 6), lane = threadIdx.x & 63;
    const float4* tr = (const float4*)(t + (size_t)row * DM) + lane;
    const float4* xr = (const float4*)(xin + (size_t)row * DM) + lane;
    float4 v[4], xv[4]; float ss = 0.f;
#pragma unroll
    for (int j = 0; j < 4; ++j) { v[j] = tr[64 * j]; xv[j] = xr[64 * j]; ss += v[j].x * v[j].x + v[j].y * v[j].y + v[j].z * v[j].z + v[j].w * v[j].w; }
    const float r = rsqrtf(wave_sum(ss) * (1.f / DM) + NORM_EPS);
    float s2 = 0.f;
#pragma unroll
    for (int j = 0; j < 4; ++j) {
        const int c = lane * 4 + 256 * j; const float4 gg = *(const float4*)(gpost + c);
        xv[j].x += v[j].x * r * gg.x; xv[j].y += v[j].y * r * gg.y; xv[j].z += v[j].z * r * gg.z; xv[j].w += v[j].w * r * gg.w;
        s2 += xv[j].x * xv[j].x + xv[j].y * xv[j].y + xv[j].z * xv[j].z + xv[j].w * xv[j].w;
        *(float4*)(xout + (size_t)row * DM + c) = xv[j];
    }
    if (gnext) {
        const float r2 = rsqrtf(wave_sum(s2) * (1.f / DM) + NORM_EPS);
#pragma unroll
        for (int j = 0; j < 4; ++j) {
            const int c = lane * 4 + 256 * j; const float4 gg = *(const float4*)(gnext + c);
            ushort4 o; o.x = f2bf(xv[j].x * r2 * gg.x); o.y = f2bf(xv[j].y * r2 * gg.y); o.z = f2bf(xv[j].z * r2 * gg.z); o.w = f2bf(xv[j].w * r2 * gg.w);
            *(ushort4*)(xn + (size_t)row * DM + c) = o;
        }
    }
}

enum { EPI_INPROJ = 0, EPI_GATED_F32 = 1, EPI_MERGE = 2, EPI_F32 = 3, EPI_UP = 4, EPI_GATE = 5 };
struct EpiP { bf16 *u, *vg, *va, *ga, *gb; float* t; const bf16* gate; bf16* o; int ldo; int pad; };
template <int MODE>
__global__ __launch_bounds__(256) void gemm_naive(const bf16* __restrict__ A, int lda, const float* __restrict__ W, int ldw, int K, EpiP p) {
    __shared__ float As[16][68];
    __shared__ float Bs[16][68];
    const int t = threadIdx.x, tx = t & 15, ty = t >> 4;
    const int m0 = blockIdx.y * 64, n0 = blockIdx.x * 64;
    float acc[4][4];
#pragma unroll
    for (int i = 0; i < 4; ++i)
#pragma unroll
        for (int j = 0; j < 4; ++j) acc[i][j] = 0.f;
    for (int k0 = 0; k0 < K; k0 += 16) {
        { const int r = t >> 2, kk = (t & 3) * 4; const ushort4 v = *(const ushort4*)(A + (size_t)(m0 + r) * lda + k0 + kk);
          As[kk][r] = bf2f(v.x); As[kk + 1][r] = bf2f(v.y); As[kk + 2][r] = bf2f(v.z); As[kk + 3][r] = bf2f(v.w); }
        { const int kk = t >> 4, c = (t & 15) * 4; *(float4*)&Bs[kk][c] = *(const float4*)(W + (size_t)(k0 + kk) * ldw + n0 + c); }
        __syncthreads();
#pragma unroll
        for (int kk = 0; kk < 16; ++kk) {
            const float4 a = *(const float4*)&As[kk][ty * 4]; const float4 b = *(const float4*)&Bs[kk][tx * 4];
            const float av[4] = {a.x, a.y, a.z, a.w}, bv[4] = {b.x, b.y, b.z, b.w};
#pragma unroll
            for (int i = 0; i < 4; ++i)
#pragma unroll
                for (int j = 0; j < 4; ++j) acc[i][j] += av[i] * bv[j];
        }
        __syncthreads();
    }
#pragma unroll
    for (int i = 0; i < 4; ++i) {
        const size_t row = (size_t)(m0 + ty * 4 + i); const int c = n0 + tx * 4;
        float v[4] = {acc[i][0], acc[i][1], acc[i][2], acc[i][3]};
        if (MODE == EPI_INPROJ) {
            if (c < 512) { ushort4 o; o.x = f2bf(gelu_tanh(v[0])); o.y = f2bf(gelu_tanh(v[1])); o.z = f2bf(gelu_tanh(v[2])); o.w = f2bf(gelu_tanh(v[3])); *(ushort4*)(p.u + row * 512 + c) = o; }
            else if (c < 1024) { ushort4 o; o.x = f2bf(gelu_tanh(v[0])); o.y = f2bf(gelu_tanh(v[1])); o.z = f2bf(gelu_tanh(v[2])); o.w = f2bf(gelu_tanh(v[3])); *(ushort4*)(p.vg + row * 512 + c - 512) = o; }
            else if (c < 2048) { *(float4*)(p.t + row * 1024 + c - 1024) = make_float4(v[0], v[1], v[2], v[3]); }
            else if (c < 2560) { ushort4 o; o.x = f2bf(v[0]); o.y = f2bf(v[1]); o.z = f2bf(v[2]); o.w = f2bf(v[3]); *(ushort4*)(p.va + row * 512 + c - 2048) = o; }
            else if (c < 3584) { ushort4 o; o.x = f2bf(sigmoidf_(v[0])); o.y = f2bf(sigmoidf_(v[1])); o.z = f2bf(sigmoidf_(v[2])); o.w = f2bf(sigmoidf_(v[3])); *(ushort4*)(p.ga + row * 1024 + c - 2560) = o; }
            else { ushort4 o; o.x = f2bf(sigmoidf_(v[0])); o.y = f2bf(sigmoidf_(v[1])); o.z = f2bf(sigmoidf_(v[2])); o.w = f2bf(sigmoidf_(v[3])); *(ushort4*)(p.gb + row * 1024 + c - 3584) = o; }
        } else if (MODE == EPI_GATED_F32) {
            const ushort4 g = *(const ushort4*)(p.gate + row * 1024 + c);
            *(float4*)(p.t + row * 1024 + c) = make_float4(v[0] * bf2f(g.x), v[1] * bf2f(g.y), v[2] * bf2f(g.z), v[3] * bf2f(g.w));
        } else if (MODE == EPI_MERGE) {
            const ushort4 g = *(const ushort4*)(p.gate + row * 1024 + c); const float4 tv = *(const float4*)(p.t + row * 1024 + c);
            ushort4 o; o.x = f2bf(tv.x + v[0] * bf2f(g.x)); o.y = f2bf(tv.y + v[1] * bf2f(g.y)); o.z = f2bf(tv.z + v[2] * bf2f(g.z)); o.w = f2bf(tv.w + v[3] * bf2f(g.w));
            *(ushort4*)(p.o + row * 1024 + c) = o;
        } else if (MODE == EPI_F32) {
            *(float4*)(p.t + row * 1024 + c) = make_float4(v[0], v[1], v[2], v[3]);
        } else if (MODE == EPI_UP) {
            ushort4 o; o.x = f2bf(v[0]); o.y = f2bf(v[1]); o.z = f2bf(v[2]); o.w = f2bf(v[3]); *(ushort4*)(p.o + row * DFF + c) = o;
        } else if (MODE == EPI_GATE) {
            const ushort4 h = *(const ushort4*)(p.o + row * DFF + c);
            ushort4 o; o.x = f2bf(v[0] * sigmoidf_(v[0]) * bf2f(h.x)); o.y = f2bf(v[1] * sigmoidf_(v[1]) * bf2f(h.y)); o.z = f2bf(v[2] * sigmoidf_(v[2]) * bf2f(h.z)); o.w = f2bf(v[3] * sigmoidf_(v[3]) * bf2f(h.w));
            *(ushort4*)(p.o + row * DFF + c) = o;
        }
    }
}

__global__ void rope_kernel(const float* __restrict__ t1, const float* __restrict__ cosT, const float* __restrict__ sinT, bf16* __restrict__ Q, bf16* __restrict__ Kk) {
    const int i = blockIdx.x * blockDim.x + threadIdx.x; if (i >= MTOK * 512) return;
    const int f = i & 31, hh = (i >> 5) & 7, which = (i >> 8) & 1, row = i >> 9;
    const float c = cosT[row * 32 + f], s = sinT[row * 32 + f];
    const float* src = t1 + (size_t)row * 1024 + which * 512 + hh * 64;
    const float x1 = src[f], x2 = src[f + 32];
    float o1 = x1 * c - x2 * s, o2 = x2 * c + x1 * s;
    bf16* dst = (which ? Kk : Q) + (size_t)row * 512 + hh * 64;
    if (!which) { o1 *= QSCALE; o2 *= QSCALE; }
    dst[f] = f2bf(o1); dst[f + 32] = f2bf(o2);
}

__global__ void kbar_kernel(const bf16* __restrict__ Kk, float* __restrict__ kbar) {
    const int i = blockIdx.x * blockDim.x + threadIdx.x; if (i >= NBATCH * NBLK * 512) return;
    const int col = i & 511, bn = i >> 9;
    const bf16* p = Kk + (size_t)bn * MBLK * 512 + col; float s = 0.f;
    for (int r = 0; r < MBLK; ++r) s += bf2f(p[(size_t)r * 512]);
    kbar[i] = s * (1.f / MBLK);
}

__global__ __launch_bounds__(64) void attn_naive(const bf16* __restrict__ Q, const bf16* __restrict__ Kk, const bf16* __restrict__ V, const float* __restrict__ kbar, bf16* __restrict__ YB) {
    __shared__ float qs[64]; __shared__ float ps[1024]; __shared__ float gs[8];
    const int lane = threadIdx.x, h = blockIdx.x % NH, row = blockIdx.x / NH, b = row / SEQ, s = row % SEQ, qb = s / MBLK;
    qs[lane] = bf2f(Q[(size_t)row * 512 + h * 64 + lane]);
    __syncthreads();
    if (lane < 8) { float g = -INFINITY; if (lane < qb) { g = 0.f; const float* kb = kbar + (size_t)(b * NBLK + lane) * 512 + h * 64; for (int d = 0; d < 64; ++d) g += qs[d] * kb[d]; } gs[lane] = g; }
    __syncthreads();
    unsigned selmask = 0;
    for (int n = 0; n < qb; ++n) { int cnt = 0; const float gn = gs[n]; for (int m = 0; m < qb; ++m) { const float gm = gs[m]; if (m != n && (gm > gn || (gm == gn && m < n))) ++cnt; } if (cnt < 3) selmask |= 1u << n; }
    float mx = -INFINITY; int slot = 0;
    for (int n = 0; n <= qb; ++n) {
        const bool own = (n == qb); if (!own && !((selmask >> n) & 1u)) continue;
#pragma unroll
        for (int j = 0; j < 4; ++j) {
            const int key = lane + 64 * j, pos = n * MBLK + key; float sc = -INFINITY;
            if (!own || pos <= s) {
                const uint4* kp = (const uint4*)(Kk + (size_t)(b * SEQ + pos) * 512 + h * 64); float a = 0.f;
#pragma unroll
                for (int c = 0; c < 8; ++c) { const uint4 w = kp[c]; const unsigned ww[4] = {w.x, w.y, w.z, w.w};
#pragma unroll
                    for (int e = 0; e < 4; ++e) { a += qs[c * 8 + 2 * e] * __uint_as_float(ww[e] << 16); a += qs[c * 8 + 2 * e + 1] * __uint_as_float(ww[e] & 0xffff0000u); } }
                sc = a;
            }
            ps[slot * 256 + key] = sc; mx = fmaxf(mx, sc);
        }
        ++slot;
    }
    mx = wave_max(mx);
    __syncthreads();
    float sum = 0.f;
    for (int i = lane; i < slot * 256; i += 64) { const float pp = exp2f(ps[i] - mx); ps[i] = pp; sum += pp; }
    sum = wave_sum(sum);
    __syncthreads();
    float o = 0.f; slot = 0;
    for (int n = 0; n <= qb; ++n) {
        const bool own = (n == qb); if (!own && !((selmask >> n) & 1u)) continue;
        const bf16* vp = V + (size_t)(b * SEQ + n * MBLK) * 512 + h * 64 + lane;
        for (int key = 0; key < 256; ++key) { const float pp = ps[slot * 256 + key]; o += pp * bf2f(vp[(size_t)key * 512]); }
        ++slot;
    }
    YB[(size_t)row * 512 + h * 64 + lane] = f2bf(o / sum);
}

__global__ __launch_bounds__(256) void sgu_naive(const bf16* __restrict__ U, const bf16* __restrict__ VG, const float* __restrict__ ws, const float* __restrict__ bs, const float* __restrict__ lng, const float* __restrict__ lnb, bf16* __restrict__ YA) {
    __shared__ float mu[128]; __shared__ float rs[128]; __shared__ float vn[128][65];
    const int t = threadIdx.x, lane = t & 63, w = t >> 6;
    const int g = blockIdx.x % GMG, c = (blockIdx.x / GMG) % (SEQ / GMC), b = blockIdx.x / (GMG * (SEQ / GMC));
    const size_t row0 = (size_t)b * SEQ + (size_t)c * GMC;
    for (int r = w * 32; r < w * 32 + 32; ++r) {
        const uint4 raw = *(const uint4*)(VG + (row0 + r) * 512 + lane * 8); const unsigned ww[4] = {raw.x, raw.y, raw.z, raw.w};
        float v[8]; float s1 = 0.f;
#pragma unroll
        for (int e = 0; e < 4; ++e) { v[2 * e] = __uint_as_float(ww[e] << 16); v[2 * e + 1] = __uint_as_float(ww[e] & 0xffff0000u); s1 += v[2 * e] + v[2 * e + 1]; }
        const float mean = wave_sum(s1) * (1.f / 512.f); float s2 = 0.f;
#pragma unroll
        for (int e = 0; e < 8; ++e) { const float d = v[e] - mean; s2 += d * d; }
        const float var = wave_sum(s2) * (1.f / 512.f);
        if (lane == 0) { mu[r] = mean; rs[r] = rsqrtf(var + NORM_EPS); }
    }
    __syncthreads();
    for (int idx = t; idx < 128 * 64; idx += 256) { const int j = idx >> 6, d = idx & 63; const float v = bf2f(VG[(row0 + j) * 512 + g * 64 + d]); vn[j][d] = (v - mu[j]) * rs[j] * lng[g * 64 + d] + lnb[g * 64 + d]; }
    __syncthreads();
    for (int idx = t; idx < 128 * 64; idx += 256) {
        const int i = idx >> 6, d = idx & 63; const float* wr = ws + ((size_t)g * 128 + i) * 128; float a = 0.f;
        for (int j = 0; j <= i; ++j) a += wr[j] * vn[j][d];
        a += bs[g * 128 + i];
        const size_t o = (row0 + i) * 512 + g * 64 + d;
        YA[o] = f2bf(bf2f(U[o]) * a);
    }
}

extern "C" void kernel_launch(void* const* d_in, const int* in_sizes, int n_in, void* d_out, int out_size, void* d_ws, size_t ws_size, hipStream_t stream) {
    if (n_in != 16 || ws_size < WS_END) { fprintf(stderr, "kernel_launch: unexpected inputs (n_in %d, ws %zu)\n", n_in, ws_size); return; }
    const float* x = (const float*)d_in[0]; const int* positions = (const int*)d_in[1];
    const float* w_in = (const float*)d_in[2]; const float* w_s = (const float*)d_in[3]; const float* b_s = (const float*)d_in[4];
    const float* ln_g = (const float*)d_in[5]; const float* ln_b = (const float*)d_in[6];
    const float* w_pa = (const float*)d_in[7]; const float* w_pb = (const float*)d_in[8]; const float* w_out = (const float*)d_in[9];
    const float* g_mix_pre = (const float*)d_in[10]; const float* g_mix_post = (const float*)d_in[11];
    const float* g_ffn_pre = (const float*)d_in[12]; const float* g_ffn_post = (const float*)d_in[13];
    const float* w_gu = (const float*)d_in[14]; const float* w_down = (const float*)d_in[15];
    float* out = (float*)d_out; unsigned char* ws = (unsigned char*)d_ws;
    float* cosT = (float*)(ws + WS_COS); float* sinT = (float*)(ws + WS_SIN); float* kbar = (float*)(ws + WS_KBAR);
    bf16* XN = (bf16*)(ws + WS_XN); bf16* U = (bf16*)(ws + WS_U); bf16* VG = (bf16*)(ws + WS_VG); bf16* Q = (bf16*)(ws + WS_Q); bf16* Kk = (bf16*)(ws + WS_K);
    bf16* VA = (bf16*)(ws + WS_VA); bf16* GA = (bf16*)(ws + WS_GA); bf16* GB = (bf16*)(ws + WS_GB); bf16* YA = (bf16*)(ws + WS_YA); bf16* YB = (bf16*)(ws + WS_YB);
    bf16* MERGED = (bf16*)(ws + WS_MERGED); float* T1 = (float*)(ws + WS_T1); float* T3 = (float*)(ws + WS_T3); bf16* H = (bf16*)(ws + WS_H); float* T6 = (float*)(ws + WS_T6);

    rope_table_kernel<<<MTOK * 32 / 256, 256, 0, stream>>>(positions, cosT, sinT);
    rms_to_bf16_kernel<<<MTOK / 4, 256, 0, stream>>>(x, g_mix_pre, XN);
    for (int l = 0; l < DEPTH; ++l) {
        const float* xin = (l == 0) ? x : out;
        EpiP p{}; p.u = U; p.vg = VG; p.va = VA; p.ga = GA; p.gb = GB; p.t = T1;
        gemm_naive<EPI_INPROJ><<<dim3(INW / 64, MTOK / 64), 256, 0, stream>>>(XN, DM, w_in + (size_t)l * DM * INW, INW, DM, p);
        rope_kernel<<<MTOK * 512 / 256, 256, 0, stream>>>(T1, cosT, sinT, Q, Kk);
        kbar_kernel<<<NBATCH * NBLK * 512 / 256, 256, 0, stream>>>(Kk, kbar);
        attn_naive<<<MTOK * NH, 64, 0, stream>>>(Q, Kk, VA, kbar, YB);
        sgu_naive<<<NBATCH * (SEQ / GMC) * GMG, 256, 0, stream>>>(U, VG, w_s + (size_t)l * GMG * GMC * GMC, b_s + (size_t)l * GMG * GMC, ln_g + (size_t)l * GW, ln_b + (size_t)l * GW, YA);
        EpiP p3{}; p3.t = T3; p3.gate = GA;
        gemm_naive<EPI_GATED_F32><<<dim3(DM / 64, MTOK / 64), 256, 0, stream>>>(YA, GW, w_pa + (size_t)l * GW * DM, DM, GW, p3);
        EpiP p3b{}; p3b.t = T3; p3b.gate = GB; p3b.o = MERGED;
        gemm_naive<EPI_MERGE><<<dim3(DM / 64, MTOK / 64), 256, 0, stream>>>(YB, AW, w_pb + (size_t)l * AW * DM, DM, AW, p3b);
        EpiP p4{}; p4.t = T3;
        gemm_naive<EPI_F32><<<dim3(DM / 64, MTOK / 64), 256, 0, stream>>>(MERGED, DM, w_out + (size_t)l * DM * DM, DM, DM, p4);
        rownorm_kernel<<<MTOK / 4, 256, 0, stream>>>(T3, xin, g_mix_post + (size_t)l * DM, out, g_ffn_pre + (size_t)l * DM, XN);
        EpiP p5{}; p5.o = H;
        gemm_naive<EPI_UP><<<dim3(DFF / 64, MTOK / 64), 256, 0, stream>>>(XN, DM, w_gu + (size_t)l * DM * 2 * DFF + DFF, 2 * DFF, DM, p5);
        gemm_naive<EPI_GATE><<<dim3(DFF / 64, MTOK / 64), 256, 0, stream>>>(XN, DM, w_gu + (size_t)l * DM * 2 * DFF, 2 * DFF, DM, p5);
        EpiP p6{}; p6.t = T6;
        gemm_naive<EPI_F32><<<dim3(DM / 64, MTOK / 64), 256, 0, stream>>>(H, DFF, w_down + (size_t)l * DFF * DM, DM, DFF, p6);
        rownorm_kernel<<<MTOK / 4, 256, 0, stream>>>(T6, out, g_ffn_post + (size_t)l * DM, out, (l + 1 < DEPTH) ? g_mix_pre + (size_t)(l + 1) * DM : nullptr, XN);
    }
}
```
